# Optimizing an MI355X kernel written in HIP

```python
import jax
import jax.numpy as jnp
from jax import lax
import numpy as np

D_MODEL = 1024
BATCH = 1
SEQ = 16384
DEPTH = 2
DEC_BATCH = 32
DEC_SEQ = 64
PAST_LEN = 1024

CHUNK = 64
N_EVEN = (DEPTH + 1) // 2
N_ODD = DEPTH // 2

POOL_WIDTH = D_MODEL // 2
POOL_GROUPS = 4
POOL_GC = POOL_WIDTH // POOL_GROUPS
POOL_WINDOWS = (2, 4, 8, 16)
POOL_CTX = max(POOL_WINDOWS) - 1

HEAD_DIM = 64
N_Q_HEADS = (D_MODEL // 2) // HEAD_DIM
N_KV_HEADS = 2
Q_PER_KV = N_Q_HEADS // N_KV_HEADS
WINDOW = 128
SWA_CTX = -(-WINDOW // CHUNK) * CHUNK

CONV_WIDTH = D_MODEL // 2
CONV_K = 31
CONV_CTX = CONV_K - 1

GMLP_WIDTH = D_MODEL // 2
GMLP_GROUPS = 4
GMLP_GC = GMLP_WIDTH // GMLP_GROUPS
GMLP_CHUNK = 128

D_FF = -(-(8 * D_MODEL) // (3 * 256)) * 256

EVEN_IN = POOL_WIDTH + N_Q_HEADS * HEAD_DIM + 2 * N_KV_HEADS * HEAD_DIM
EVEN_OUT = POOL_WIDTH + N_Q_HEADS * HEAD_DIM
ODD_IN = 2 * CONV_WIDTH + 2 * GMLP_WIDTH
ODD_OUT = CONV_WIDTH + GMLP_WIDTH

kernel_name = 'hybrid_streaming_pool_swa_conformer_gmlp_step'


def rms_norm(x, g, eps=1e-6):
    xf = x.astype(jnp.float32)
    y = xf * lax.rsqrt(jnp.mean(xf * xf, axis=-1, keepdims=True) + eps)
    return (y * g.astype(jnp.float32)).astype(x.dtype)


def layer_norm(x, g, b, eps=1e-5):
    xf = x.astype(jnp.float32)
    mu = jnp.mean(xf, axis=-1, keepdims=True)
    xc = xf - mu
    var = jnp.mean(xc * xc, axis=-1, keepdims=True)
    return (xc * lax.rsqrt(var + eps) * g.astype(jnp.float32) + b.astype(jnp.float32)).astype(x.dtype)


def alibi_slopes():
    return 2.0 ** (-8.0 * jnp.arange(1, N_Q_HEADS + 1, dtype=jnp.float32) / N_Q_HEADS)


def pool_mixer(u, prefix, pos0, w_pool, scale):
    b, t = u.shape[0], u.shape[1]
    ext = jnp.concatenate([prefix, u], axis=1).astype(jnp.float32)
    cs = jnp.cumsum(ext, axis=1)
    cs = jnp.concatenate([jnp.zeros_like(cs[:, :1]), cs], axis=1)
    pos = pos0 + jnp.arange(t)
    means = []
    for g, w in enumerate(POOL_WINDOWS):
        sl = slice(g * POOL_GC, (g + 1) * POOL_GC)
        hi = cs[:, POOL_CTX + 1:POOL_CTX + 1 + t, sl]
        lo = cs[:, POOL_CTX + 1 - w:POOL_CTX + 1 - w + t, sl]
        cnt = jnp.minimum(pos + 1, w).astype(jnp.float32)[None, :, None]
        means.append((hi - lo) / cnt)
    pooled = jnp.concatenate(means, axis=-1) - u.astype(jnp.float32)
    pg = pooled.reshape(b, t, POOL_GROUPS, POOL_GC)
    y = jnp.einsum('btgc,gcd->btgd', pg, w_pool.astype(jnp.float32)).reshape(b, t, POOL_WIDTH)
    return (y * scale.astype(jnp.float32)).astype(u.dtype)


def swa_attention(q, k, v, k_prev, v_prev, pos0, sinks):
    b, t = q.shape[0], q.shape[1]
    n_blk = -(-t // CHUNK)
    pad = n_blk * CHUNK - t
    nc = SWA_CTX // CHUNK
    span = (nc + 1) * CHUNK
    padw = ((0, 0), (0, pad), (0, 0), (0, 0))
    q = jnp.pad(q, padw)
    k_ext = jnp.concatenate([k_prev, jnp.pad(k, padw)], axis=1)
    v_ext = jnp.concatenate([v_prev, jnp.pad(v, padw)], axis=1)
    k_ch = k_ext.reshape(b, n_blk + nc, CHUNK, N_KV_HEADS, HEAD_DIM)
    v_ch = v_ext.reshape(b, n_blk + nc, CHUNK, N_KV_HEADS, HEAD_DIM)
    k_blk = jnp.concatenate([k_ch[:, j:j + n_blk] for j in range(nc + 1)], axis=2)
    v_blk = jnp.concatenate([v_ch[:, j:j + n_blk] for j in range(nc + 1)], axis=2)
    q_blk = q.reshape(b, n_blk, CHUNK, N_KV_HEADS, Q_PER_KV, HEAD_DIM)
    s = jnp.einsum('bnqkgd,bnskd->bnkgqs', q_blk, k_blk,
                   preferred_element_type=jnp.float32) * (HEAD_DIM ** -0.5)
    q_pos = pos0 + jnp.arange(n_blk * CHUNK).reshape(n_blk, CHUNK)
    k_pos = pos0 - SWA_CTX + jnp.arange(n_blk)[:, None] * CHUNK + jnp.arange(span)[None, :]
    dist = jnp.abs(q_pos[:, :, None] - k_pos[:, None, :]).astype(jnp.float32)
    slopes = alibi_slopes().reshape(N_KV_HEADS, Q_PER_KV)
    s = s - slopes[None, None, :, :, None, None] * dist[None, :, None, None, :, :]
    valid = (k_pos >= 0) & (k_pos < pos0 + t)
    s = jnp.where(valid[None, :, None, None, None, :], s, -jnp.inf)
    sink = sinks.astype(jnp.float32).reshape(N_KV_HEADS, Q_PER_KV)[None, None, :, :, None, None]
    m = jnp.maximum(jnp.max(s, axis=-1, keepdims=True), sink)
    p = jnp.exp(s - m)
    denom = jnp.sum(p, axis=-1, keepdims=True) + jnp.exp(sink - m)
    o = jnp.einsum('bnkgqs,bnskd->bnqkgd', (p / denom).astype(v.dtype), v_blk)
    return o.reshape(b, n_blk * CHUNK, N_Q_HEADS * HEAD_DIM)[:, :t]


def depthwise_causal_conv(ext, w, bias):
    y = lax.conv_general_dilated(ext, w[:, None, :].astype(ext.dtype), window_strides=(1,),
                                 padding='VALID', dimension_numbers=('NWC', 'WIO', 'NWC'),
                                 feature_group_count=ext.shape[-1])
    return y + bias.astype(ext.dtype)


def gmlp_gate(u, v, ln_g, ln_b, w_sp, b_sp):
    b, t = v.shape[0], v.shape[1]
    vn = layer_norm(v, ln_g, ln_b)
    n = -(-t // GMLP_CHUNK)
    pad = n * GMLP_CHUNK - t
    vp = jnp.pad(vn, ((0, 0), (0, pad), (0, 0))).reshape(b, n, GMLP_CHUNK, GMLP_GROUPS, GMLP_GC)
    mask = jnp.tril(jnp.ones((GMLP_CHUNK, GMLP_CHUNK), dtype=w_sp.dtype))
    w = (w_sp * mask[None]).astype(v.dtype)
    s = jnp.einsum('gij,bnjgc->bnigc', w, vp) + b_sp.T.astype(v.dtype)[None, None, :, :, None]
    s = s.reshape(b, n * GMLP_CHUNK, GMLP_WIDTH)[:, :t]
    return u * s, vn


def even_mixer(x, g_mix, pool_prev, k_prev, v_prev, pos0,
               w_in, q_g, k_g, sinks, w_pool, pool_scale, w_out):
    b, t = x.shape[0], x.shape[1]
    h = rms_norm(x, g_mix)
    z = h @ w_in
    o1 = POOL_WIDTH
    o2 = o1 + N_Q_HEADS * HEAD_DIM
    o3 = o2 + N_KV_HEADS * HEAD_DIM
    u = z[..., :o1]
    q = rms_norm(z[..., o1:o2].reshape(b, t, N_Q_HEADS, HEAD_DIM), q_g)
    k = rms_norm(z[..., o2:o3].reshape(b, t, N_KV_HEADS, HEAD_DIM), k_g)
    v = z[..., o3:].reshape(b, t, N_KV_HEADS, HEAD_DIM)
    a_out = pool_mixer(u, pool_prev, pos0, w_pool, pool_scale)
    b_out = swa_attention(q, k, v, k_prev, v_prev, pos0, sinks)
    x = x + jnp.concatenate([a_out, b_out], axis=-1) @ w_out
    new_pool = jnp.concatenate([pool_prev, u], axis=1)[:, -POOL_CTX:]
    new_k = jnp.concatenate([k_prev, k], axis=1)[:, -SWA_CTX:]
    new_v = jnp.concatenate([v_prev, v], axis=1)[:, -SWA_CTX:]
    return x, new_pool, new_k, new_v


def odd_mixer(x, g_mix, conv_prev, w_in, conv_w, conv_b, conv_ln_g, conv_ln_b,
              gmlp_ln_g, gmlp_ln_b, gmlp_w, gmlp_b, w_out):
    h = rms_norm(x, g_mix)
    z = h @ w_in
    c1 = CONV_WIDTH
    c2 = 2 * CONV_WIDTH
    c3 = c2 + GMLP_WIDTH
    glu = z[..., :c1] * jax.nn.sigmoid(z[..., c1:c2])
    ext = jnp.concatenate([conv_prev, glu], axis=1)
    c = depthwise_causal_conv(ext, conv_w, conv_b)
    c = jax.nn.silu(layer_norm(c, conv_ln_g, conv_ln_b))
    zu = jax.nn.gelu(z[..., c2:c3], approximate=False)
    zv = jax.nn.gelu(z[..., c3:], approximate=False)
    d, vn = gmlp_gate(zu, zv, gmlp_ln_g, gmlp_ln_b, gmlp_w, gmlp_b)
    x = x + jnp.concatenate([c, d], axis=-1) @ w_out
    return x, ext[:, -CONV_CTX:], vn


def swiglu_block(x, g, w_gate, w_up, w_down):
    h = rms_norm(x, g)
    return x + (jax.nn.silu(h @ w_gate) * (h @ w_up)) @ w_down


def setup_inputs(seed: int = 0) -> dict:
    key = jax.random.key(seed)
    ks = iter(jax.random.split(key, 40))
    f32 = jnp.float32

    def nrm(shape, scale=1.0):
        return jax.random.normal(next(ks), shape, f32) * scale

    def gain(shape):
        return 1.0 + 0.05 * jax.random.normal(next(ks), shape, f32)

    return {
        'x_prompt': nrm((BATCH, SEQ, D_MODEL)),
        'x_sample': nrm((DEC_BATCH, DEC_SEQ, D_MODEL)),
        'state_pool': nrm((N_EVEN, DEC_BATCH, POOL_CTX, POOL_WIDTH), 0.6),
        'state_swa_k': nrm((N_EVEN, DEC_BATCH, SWA_CTX, N_KV_HEADS, HEAD_DIM)),
        'state_swa_v': nrm((N_EVEN, DEC_BATCH, SWA_CTX, N_KV_HEADS, HEAD_DIM), 0.6),
        'state_conv': nrm((N_ODD, DEC_BATCH, CONV_CTX, CONV_WIDTH), 0.4),
        'norm_mix': gain((DEPTH, D_MODEL)),
        'norm_ffn': gain((DEPTH, D_MODEL)),
        'w_in_even': nrm((N_EVEN, D_MODEL, EVEN_IN), D_MODEL ** -0.5),
        'q_norm': gain((N_EVEN, HEAD_DIM)),
        'k_norm': gain((N_EVEN, HEAD_DIM)),
        'attn_sinks': nrm((N_EVEN, N_Q_HEADS), 0.5),
        'pool_w': nrm((N_EVEN, POOL_GROUPS, POOL_GC, POOL_GC), POOL_GC ** -0.5),
        'pool_scale': gain((N_EVEN, POOL_WIDTH)),
        'w_out_even': nrm((N_EVEN, EVEN_OUT, D_MODEL), EVEN_OUT ** -0.5),
        'w_in_odd': nrm((N_ODD, D_MODEL, ODD_IN), D_MODEL ** -0.5),
        'conv_w': nrm((N_ODD, CONV_K, CONV_WIDTH), CONV_K ** -0.5),
        'conv_b': nrm((N_ODD, CONV_WIDTH), 0.02),
        'conv_ln_g': gain((N_ODD, CONV_WIDTH)),
        'conv_ln_b': nrm((N_ODD, CONV_WIDTH), 0.02),
        'gmlp_ln_g': gain((N_ODD, GMLP_WIDTH)),
        'gmlp_ln_b': nrm((N_ODD, GMLP_WIDTH), 0.02),
        'gmlp_w': nrm((N_ODD, GMLP_GROUPS, GMLP_CHUNK, GMLP_CHUNK), GMLP_CHUNK ** -0.5),
        'gmlp_b': gain((N_ODD, GMLP_GROUPS, GMLP_CHUNK)),
        'w_out_odd': nrm((N_ODD, ODD_OUT, D_MODEL), ODD_OUT ** -0.5),
        'ffn_gate': nrm((DEPTH, D_MODEL, D_FF), D_MODEL ** -0.5),
        'ffn_up': nrm((DEPTH, D_MODEL, D_FF), D_MODEL ** -0.5),
        'ffn_down': nrm((DEPTH, D_FF, D_MODEL), D_FF ** -0.5),
    }


def reference(x_prompt, x_sample, state_pool, state_swa_k, state_swa_v, state_conv,
              norm_mix, norm_ffn, w_in_even, q_norm, k_norm, attn_sinks, pool_w, pool_scale,
              w_out_even, w_in_odd, conv_w, conv_b, conv_ln_g, conv_ln_b, gmlp_ln_g, gmlp_ln_b,
              gmlp_w, gmlp_b, w_out_odd, ffn_gate, ffn_up, ffn_down):
    xp, xs = x_prompt, x_sample
    bp = xp.shape[0]
    pool_p, pool_s, kp_l, ks_l, vp_l, vs_l, conv_p, conv_s, gv_s = [], [], [], [], [], [], [], [], []
    for layer in range(DEPTH):
        if layer % 2 == 0:
            i = layer // 2
            prm = (w_in_even[i], q_norm[i], k_norm[i], attn_sinks[i], pool_w[i], pool_scale[i], w_out_even[i])
            zero_pool = jnp.zeros((bp, POOL_CTX, POOL_WIDTH), xp.dtype)
            zero_kv = jnp.zeros((bp, SWA_CTX, N_KV_HEADS, HEAD_DIM), xp.dtype)
            xp, pp, kk, vv = even_mixer(xp, norm_mix[layer], zero_pool, zero_kv, zero_kv, 0, *prm)
            pool_p.append(pp)
            kp_l.append(kk)
            vp_l.append(vv)
            xs, pp, kk, vv = even_mixer(xs, norm_mix[layer], state_pool[i], state_swa_k[i],
                                        state_swa_v[i], PAST_LEN, *prm)
            pool_s.append(pp)
            ks_l.append(kk)
            vs_l.append(vv)
        else:
            j = layer // 2
            prm = (w_in_odd[j], conv_w[j], conv_b[j], conv_ln_g[j], conv_ln_b[j],
                   gmlp_ln_g[j], gmlp_ln_b[j], gmlp_w[j], gmlp_b[j], w_out_odd[j])
            zero_conv = jnp.zeros((bp, CONV_CTX, CONV_WIDTH), xp.dtype)
            xp, cc, _ = odd_mixer(xp, norm_mix[layer], zero_conv, *prm)
            conv_p.append(cc)
            xs, cc, gv = odd_mixer(xs, norm_mix[layer], state_conv[j], *prm)
            conv_s.append(cc)
            gv_s.append(gv)
        xp = swiglu_block(xp, norm_ffn[layer], ffn_gate[layer], ffn_up[layer], ffn_down[layer])
        xs = swiglu_block(xs, norm_ffn[layer], ffn_gate[layer], ffn_up[layer], ffn_down[layer])
    return (xp, xs, jnp.stack(pool_p), jnp.stack(pool_s), jnp.stack(kp_l), jnp.stack(ks_l),
            jnp.stack(vp_l), jnp.stack(vs_l), jnp.stack(conv_p), jnp.stack(conv_s), jnp.stack(gv_s))
```

```cpp
#include <hip/hip_runtime.h>
#include <cstdio>
#include <cstdint>
namespace pg8 {
#define PG8_LAS __attribute__((address_space(3)))
typedef unsigned short bf16_t;
typedef short bf16x8 __attribute__((ext_vector_type(8)));
typedef float f32x4 __attribute__((ext_vector_type(4)));
typedef unsigned u32x4 __attribute__((ext_vector_type(4)));
constexpr int BM = 256, BK = 64, HALF = 128, HTB = HALF * BK * 2  , STAGE_BYTES = 8 * HTB, NXCD = 8, WGM = 8;

__host__ __device__ __forceinline__ int lds_byte(int r, int c) { const int st = (r >> 4) * 2 + (c >> 5), rr = r & 15, cc = c & 31, ob = rr * 64 + cc * 2; return st * 1024 + (ob ^ (((ob >> 9) & 1) << 5)); }
__host__ __device__ __forceinline__ void stage_rc(int b, int& R, int& C) { const int st = b / 1024, sb = b % 1024, swz = sb ^ (((sb >> 9) & 1) << 5); R = (st >> 1) * 16 + swz / 64; C = (st & 1) * 32 + (swz % 64) / 2; }
__host__ __device__ __forceinline__ int perm32(int rho) { const int n = rho >> 4, i = rho & 15; return 8 * (i >> 2) + 4 * n + (i & 3); }

struct Unit { int pm, pn; };
struct Gemm { const bf16_t* A; const bf16_t* Bt; int M, N, K; };

struct StaticOrder {
    int nM, nN, nwg, G, c;
    __host__ __device__ void init(int M, int N, int G_, int c_) { nM = M / BM; nN = N / BM; nwg = nM * nN; G = G_; c = c_; }
    __host__ __device__ bool next(int i, Unit& u) const {
        const long L = (long)i * G + c; if (L >= nwg) return false;
        int wgid = (int)L; { const int q = nwg / NXCD, r = nwg % NXCD, xcd = wgid % NXCD, off = wgid / NXCD; wgid = (xcd < r ? xcd * (q + 1) : r * (q + 1) + (xcd - r) * q) + off; }
        const int nig = WGM * nN, gid = wgid / nig, fm = gid * WGM, gsz = (nM - fm) < WGM ? (nM - fm) : WGM;
        u.pm = fm + ((wgid % nig) % gsz); u.pn = (wgid % nig) / gsz; return true;
    }
    __device__ __forceinline__ void a_ready(const Unit&) const {}
    __device__ __forceinline__ void done(const Unit&) const {}
};

__device__ __forceinline__ unsigned cvt_pk_bf16(float lo, float hi) { unsigned r; asm volatile("v_cvt_pk_bf16_f32 %0, %1, %2" : "=v"(r) : "v"(lo), "v"(hi)); return r; }
typedef float f32x2 __attribute__((ext_vector_type(2)));
__device__ __forceinline__ f32x2 gelu_pk(f32x2 v) {
    const f32x2 av = __builtin_elementwise_abs(v), d = av * 0.2316418882f + 1.0f;
    f32x2 t; t.x = __builtin_amdgcn_rcpf(d.x); t.y = __builtin_amdgcn_rcpf(d.y);
    f32x2 q = t * 0.5307027145f + (-0.7265760135f); q = q * t + 0.7107068705f; q = q * t + (-0.142248368f); q = q * t + 0.127414796f; q = q * t;
    const f32x2 s = (v * v) * (-0.72134752044f);
    f32x2 e; e.x = __builtin_amdgcn_exp2f(s.x); e.y = __builtin_amdgcn_exp2f(s.y);
    const f32x2 m = v * (q * e), r = v - m;
    f32x2 o; o.x = v.x < 0.f ? m.x : r.x; o.y = v.y < 0.f ? m.y : r.y; return o;
}
__device__ __forceinline__ f32x4 gelu4(f32x4 v) { const f32x2 a = gelu_pk((f32x2){v[0], v[1]}), b = gelu_pk((f32x2){v[2], v[3]}); return (f32x4){a.x, a.y, b.x, b.y}; }
__device__ __forceinline__ float sigmoidf_fast(float x) { return __builtin_amdgcn_rcpf(1.0f + __builtin_amdgcn_exp2f(x * -1.4426950408889634f)); }
__device__ __forceinline__ f32x4 sigmoid4(f32x4 v) { return (f32x4){sigmoidf_fast(v[0]), sigmoidf_fast(v[1]), sigmoidf_fast(v[2]), sigmoidf_fast(v[3])}; }
__device__ __forceinline__ float sum4sq(f32x4 v) { return (v[0] * v[0] + v[1] * v[1]) + (v[2] * v[2] + v[3] * v[3]); }
__device__ __forceinline__ float row_rstd(const float* ssq, int row) {
    const f32x4* p = (const f32x4*)(ssq + (size_t)row * 16);
    const f32x4 a = p[0], b = p[1], c = p[2], d = p[3];
    const float s = (((a[0] + a[1]) + (a[2] + a[3])) + ((b[0] + b[1]) + (b[2] + b[3]))) + (((c[0] + c[1]) + (c[2] + c[3])) + ((d[0] + d[1]) + (d[2] + d[3])));
    return __builtin_amdgcn_rsqf(s * (1.0f / 1024.0f) + 1e-6f);
}
__device__ __forceinline__ u32x4 pack8(f32x4 a, f32x4 b) { u32x4 w; w.x = cvt_pk_bf16(a[0], a[1]); w.y = cvt_pk_bf16(a[2], a[3]); w.z = cvt_pk_bf16(b[0], b[1]); w.w = cvt_pk_bf16(b[2], b[3]); return w; }

struct EpiEvenIn {
    static constexpr bool PERM = true, AFTER_DRAIN = false;
    bf16_t* Z; const float* ssq; const float* qg; const float* kg;
    __device__ __forceinline__ void operator()(const f32x4 (&acc)[2][2][4][2], const Unit& u, int wr, int wc, int fr, int fq) const {
        const int row0 = u.pm * BM + wr * 64 + fr;
        const float* gain = nullptr;
        if (u.pn == 2 || u.pn == 3) gain = qg; else if (u.pn == 4 && wc < 2) gain = kg;
        f32x4 gv[2][2];
#pragma unroll
        for (int bj = 0; bj < 2; ++bj)
#pragma unroll
            for (int n = 0; n < 2; ++n) gv[bj][n] = gain ? *(const f32x4*)(gain + 32 * bj + 8 * fq + 4 * n) : (f32x4){1.f, 1.f, 1.f, 1.f};
        const int col0 = u.pn * BM + wc * 64 + 8 * fq;
#pragma unroll
        for (int ai = 0; ai < 2; ++ai)
#pragma unroll
            for (int m = 0; m < 4; ++m) {
                const int row = row0 + ai * HALF + m * 16;
                const float rs = row_rstd(ssq, row);
                f32x4 v[2][2]; float s = 0.f;
#pragma unroll
                for (int bj = 0; bj < 2; ++bj)
#pragma unroll
                    for (int n = 0; n < 2; ++n) { v[bj][n] = acc[ai][bj][m][n] * rs; s += sum4sq(v[bj][n]); }
                if (gain) {
                    s += __shfl_xor(s, 16); s += __shfl_xor(s, 32);
                    const float hr = __builtin_amdgcn_rsqf(s * (1.0f / 64.0f) + 1e-6f);
#pragma unroll
                    for (int bj = 0; bj < 2; ++bj)
#pragma unroll
                        for (int n = 0; n < 2; ++n) v[bj][n] = v[bj][n] * hr * gv[bj][n];
                }
                bf16_t* rowp = Z + (size_t)row * 1280 + col0;
#pragma unroll
                for (int bj = 0; bj < 2; ++bj) *(u32x4*)(rowp + 32 * bj) = pack8(v[bj][0], v[bj][1]);
            }
    }
};
struct EpiResid {
    static constexpr bool PERM = true, AFTER_DRAIN = false;
    const float* xin_p; const float* xin_s; float* xout; bf16_t* xb; float* ssq; int MPROMPT;
    __device__ __forceinline__ void operator()(const f32x4 (&acc)[2][2][4][2], const Unit& u, int wr, int wc, int fr, int fq) const {
        const int row0 = u.pm * BM + wr * 64 + fr, col0 = u.pn * BM + wc * 32 + 8 * fq;
#pragma unroll
        for (int ai = 0; ai < 2; ++ai)
#pragma unroll
            for (int m = 0; m < 4; ++m) {
                const int row = row0 + ai * HALF + m * 16;
                const float* src = (row < MPROMPT ? xin_p + (size_t)row * 1024 : xin_s + (size_t)(row - MPROMPT) * 1024) + col0;
                float* dst = xout + (size_t)row * 1024 + col0; bf16_t* dstb = xb + (size_t)row * 1024 + col0;
                float s = 0.f;
#pragma unroll
                for (int bj = 0; bj < 2; ++bj) {
                    const f32x4 o0 = *(const f32x4*)(src + bj * HALF) + acc[ai][bj][m][0], o1 = *(const f32x4*)(src + bj * HALF + 4) + acc[ai][bj][m][1];
                    *(f32x4*)(dst + bj * HALF) = o0; *(f32x4*)(dst + bj * HALF + 4) = o1; s += sum4sq(o0) + sum4sq(o1);
                    *(u32x4*)(dstb + bj * HALF) = pack8(o0, o1);
                }
                s += __shfl_xor(s, 16); s += __shfl_xor(s, 32);
                if (fq == 0) ssq[(size_t)row * 16 + u.pn * 4 + wc] = s;
            }
    }
};
struct EpiSwiGLU {
    static constexpr bool PERM = true, AFTER_DRAIN = false;
    bf16_t* H; const float* ssq; int ldh;
    __device__ __forceinline__ void operator()(const f32x4 (&acc)[2][2][4][2], const Unit& u, int wr, int wc, int fr, int fq) const {
        const int row0 = u.pm * BM + wr * 64 + fr, col0 = u.pn * HALF + wc * 32 + 8 * fq;
#pragma unroll
        for (int ai = 0; ai < 2; ++ai)
#pragma unroll
            for (int m = 0; m < 4; ++m) {
                const int row = row0 + ai * HALF + m * 16;
                const float rs = row_rstd(ssq, row);
                f32x4 h[2];
#pragma unroll
                for (int n = 0; n < 2; ++n) { const f32x4 g = acc[ai][0][m][n] * rs, uu = acc[ai][1][m][n] * rs; h[n] = g * sigmoid4(g) * uu; }
                *(u32x4*)(H + (size_t)row * ldh + col0) = pack8(h[0], h[1]);
            }
    }
};
struct EpiOddIn {
    static constexpr bool PERM = true, AFTER_DRAIN = false;
    bf16_t* Z1; const float* ssq;
    __device__ __forceinline__ void operator()(const f32x4 (&acc)[2][2][4][2], const Unit& u, int wr, int wc, int fr, int fq) const {
        const int row0 = u.pm * BM + wr * 64 + fr;
#pragma unroll
        for (int ai = 0; ai < 2; ++ai)
#pragma unroll
            for (int m = 0; m < 4; ++m) {
                const int row = row0 + ai * HALF + m * 16;
                const float rs = row_rstd(ssq, row);
                bf16_t* rowp = Z1 + (size_t)row * 1536;
                if (u.pn < 4) {
                    f32x4 h[2];
#pragma unroll
                    for (int n = 0; n < 2; ++n) { const f32x4 a = acc[ai][0][m][n] * rs, g = acc[ai][1][m][n] * rs; h[n] = a * sigmoid4(g); }
                    *(u32x4*)(rowp + u.pn * HALF + wc * 32 + 8 * fq) = pack8(h[0], h[1]);
                } else {
#pragma unroll
                    for (int bj = 0; bj < 2; ++bj) { const f32x4 a = gelu4(acc[ai][bj][m][0] * rs), b = gelu4(acc[ai][bj][m][1] * rs);
                        *(u32x4*)(rowp + 512 + (u.pn - 4) * BM + bj * HALF + wc * 32 + 8 * fq) = pack8(a, b); }
                }
            }
    }
};

template <class Epi, class Sched, bool ALIGN_EPI = false, bool SP2 = false>
__device__ __forceinline__ void gemm_phase(PG8_LAS unsigned char* lds, const Gemm g, const Sched& S, const Epi& E) {
    const int tid = threadIdx.x, wid = __builtin_amdgcn_readfirstlane(tid >> 6), lane = tid & 63, wr = wid >> 2, wc = wid & 3, fr = lane & 15, fq = lane >> 4;
    const int K = g.K, nt = K / BK;
    unsigned voffA[2], voffB[2];
#pragma unroll
    for (int i = 0; i < 2; ++i) { int R, C; stage_rc(tid * 16 + i * 8192, R, C); const int Rb = Epi::PERM ? ((R & ~31) + perm32(R & 31)) : R;
        voffA[i] = (unsigned)(R * K + C) * 2u; voffB[i] = (unsigned)(Rb * K + C) * 2u; }
    const size_t kstep = (size_t)(BK * 2);
    const size_t hstep = (size_t)HALF * K * 2;
    const size_t tstep = 2 * hstep;
    const unsigned ldsw = (unsigned)wid * 1024u;
    const int aoff = lds_byte(wr * 64 + fr, fq * 8), boff = lds_byte(wc * 32 + fr, fq * 8);
#define PG8_SA(b, h) (((b) * 2 + (h)) * HTB)
#define PG8_SB(b, h) ((4 + (b) * 2 + (h)) * HTB)
#define PG8_STAGE(bufoff, gbase, voff) do { _Pragma("unroll") for (int _i = 0; _i < 2; ++_i) \
        __builtin_amdgcn_global_load_lds((const unsigned*)((const char*)(gbase) + (voff)[_i]), (PG8_LAS unsigned*)(lds + (bufoff) + ldsw + _i * 8192), 16, 0, 0); } while (0)
#define PG8_LDA(dst, b, h) do { _Pragma("unroll") for (int m = 0; m < 4; ++m) _Pragma("unroll") for (int k = 0; k < 2; ++k) dst[m][k] = *(const PG8_LAS bf16x8*)(lds + PG8_SA(b, h) + aoff + m * 2048 + k * 1024); } while (0)
#define PG8_LDB(dst, b, h) do { _Pragma("unroll") for (int n = 0; n < 2; ++n) _Pragma("unroll") for (int k = 0; k < 2; ++k) dst[n][k] = *(const PG8_LAS bf16x8*)(lds + PG8_SB(b, h) + boff + n * 2048 + k * 1024); } while (0)
#define PG8_MMA(ai, bj, At, Bt) do { __builtin_amdgcn_s_setprio(1); _Pragma("unroll") for (int m = 0; m < 4; ++m) _Pragma("unroll") for (int n = 0; n < 2; ++n) _Pragma("unroll") for (int k = 0; k < 2; ++k) \
        acc[ai][bj][m][n] = __builtin_amdgcn_mfma_f32_16x16x32_bf16(Bt[n][k], At[m][k], acc[ai][bj][m][n], 0, 0, 0); __builtin_amdgcn_s_setprio(0); } while (0)
#define PG8_WAIT_V(n) asm volatile("s_waitcnt vmcnt(" #n ")" ::: "memory")
#define PG8_WAIT_L(n) asm volatile("s_waitcnt lgkmcnt(" #n ")" ::: "memory")
#define PG8_BAR __builtin_amdgcn_s_barrier()
#define PG8_SCHED __builtin_amdgcn_sched_barrier(0)
    Unit cur, nxt; int ui = 0;
    if (!S.next(0, cur)) return;
    f32x4 acc[2][2][4][2];
#pragma unroll
    for (int a = 0; a < 2; ++a)
#pragma unroll
        for (int b = 0; b < 2; ++b)
#pragma unroll
            for (int m = 0; m < 4; ++m)
#pragma unroll
                for (int n = 0; n < 2; ++n) acc[a][b][m][n] = (f32x4){0.f, 0.f, 0.f, 0.f};
    bf16x8 At[4][2], B0[2][2], B1[2][2];
    const char* cA = (const char*)g.A + (size_t)cur.pm * tstep; const char* cB = (const char*)g.Bt + (size_t)cur.pn * tstep;
    S.a_ready(cur);
    if constexpr (SP2) {
        PG8_STAGE(PG8_SB(0, 0), cB, voffB); PG8_STAGE(PG8_SB(0, 1), cB + hstep, voffB); PG8_STAGE(PG8_SA(0, 0), cA, voffA); PG8_STAGE(PG8_SA(0, 1), cA + hstep, voffA);
        if (wr == 1) PG8_BAR;
        PG8_WAIT_V(2); PG8_BAR;
        PG8_STAGE(PG8_SB(1, 0), cB + kstep, voffB); PG8_STAGE(PG8_SA(1, 0), cA + kstep, voffA); PG8_STAGE(PG8_SB(1, 1), cB + hstep + kstep, voffB);
        PG8_WAIT_V(6); PG8_BAR;
    } else {
        PG8_STAGE(PG8_SB(0, 0), cB, voffB); PG8_STAGE(PG8_SA(0, 0), cA, voffA); PG8_STAGE(PG8_SB(0, 1), cB + hstep, voffB); PG8_STAGE(PG8_SA(0, 1), cA + hstep, voffA);
        if (wr == 1) PG8_BAR;
        PG8_WAIT_V(4); PG8_BAR;
        PG8_STAGE(PG8_SB(1, 0), cB + kstep, voffB); PG8_STAGE(PG8_SA(1, 0), cA + kstep, voffA); PG8_STAGE(PG8_SB(1, 1), cB + hstep + kstep, voffB);
        PG8_WAIT_V(6); PG8_BAR;
    }
    for (;;) {
        const bool has_next = S.next(ui + 1, nxt);
        const char* nA = has_next ? (const char*)g.A + (size_t)nxt.pm * tstep : cA; const char* nB = has_next ? (const char*)g.Bt + (size_t)nxt.pn * tstep : cB;
        for (int t = 0; t < nt; t += 2) {
            const bool last = (t == nt - 2);
            const char* a1 = cA + (size_t)(t + 1) * kstep;
            const char* a2 = last ? nA : cA + (size_t)(t + 2) * kstep; const char* b2 = last ? nB : cB + (size_t)(t + 2) * kstep;
            const char* a3 = a2 + kstep; const char* b3 = b2 + kstep;
            if (last && has_next) S.a_ready(nxt);
            if constexpr (SP2) {
            PG8_LDB(B0, 0, 0); PG8_LDB(B1, 0, 1); PG8_SCHED; PG8_LDA(At, 0, 0); PG8_STAGE(PG8_SA(1, 1), a1 + hstep, voffA);
            PG8_WAIT_V(8); PG8_WAIT_L(0); PG8_BAR; PG8_MMA(0, 0, At, B0); PG8_MMA(0, 1, At, B1); PG8_BAR; PG8_SCHED;
            PG8_LDA(At, 0, 1); PG8_STAGE(PG8_SB(0, 0), b2, voffB); PG8_STAGE(PG8_SB(0, 1), b2 + hstep, voffB); PG8_STAGE(PG8_SA(0, 0), a2, voffA);
            PG8_WAIT_V(8); PG8_WAIT_L(0); PG8_BAR; PG8_MMA(1, 0, At, B0); PG8_MMA(1, 1, At, B1); PG8_BAR; PG8_SCHED;
            PG8_LDB(B0, 1, 0); PG8_LDB(B1, 1, 1); PG8_SCHED; PG8_LDA(At, 1, 0); PG8_STAGE(PG8_SA(0, 1), a2 + hstep, voffA);
            PG8_WAIT_V(8); PG8_WAIT_L(0); PG8_BAR; PG8_MMA(0, 0, At, B0); PG8_MMA(0, 1, At, B1); PG8_BAR; PG8_SCHED;
            PG8_LDA(At, 1, 1); PG8_STAGE(PG8_SB(1, 0), b3, voffB); PG8_STAGE(PG8_SB(1, 1), b3 + hstep, voffB); PG8_STAGE(PG8_SA(1, 0), a3, voffA);
            PG8_WAIT_V(8); PG8_WAIT_L(0); PG8_BAR; PG8_MMA(1, 0, At, B0); PG8_MMA(1, 1, At, B1); PG8_BAR; PG8_SCHED;
            } else {
            PG8_LDB(B0, 0, 0); PG8_SCHED; PG8_LDA(At, 0, 0); PG8_STAGE(PG8_SA(1, 1), a1 + hstep, voffA);
            PG8_WAIT_L(8); PG8_BAR; PG8_WAIT_L(0); PG8_MMA(0, 0, At, B0); PG8_BAR; PG8_SCHED;
            PG8_LDB(B1, 0, 1); PG8_STAGE(PG8_SB(0, 0), b2, voffB);
            PG8_BAR; PG8_WAIT_L(0); PG8_MMA(0, 1, At, B1); PG8_BAR;
            PG8_LDA(At, 0, 1); PG8_STAGE(PG8_SA(0, 0), a2, voffA);
            PG8_BAR; PG8_WAIT_L(0); PG8_MMA(1, 0, At, B0); PG8_BAR; PG8_SCHED;
            PG8_STAGE(PG8_SB(0, 1), b2 + hstep, voffB);
            PG8_WAIT_V(6); PG8_BAR; PG8_MMA(1, 1, At, B1); PG8_BAR;
            PG8_LDB(B0, 1, 0); PG8_SCHED; PG8_LDA(At, 1, 0); PG8_STAGE(PG8_SA(0, 1), a2 + hstep, voffA);
            PG8_WAIT_L(8); PG8_BAR; PG8_WAIT_L(0); PG8_MMA(0, 0, At, B0); PG8_BAR; PG8_SCHED;
            PG8_LDB(B1, 1, 1); PG8_STAGE(PG8_SB(1, 0), b3, voffB);
            PG8_BAR; PG8_WAIT_L(0); PG8_MMA(0, 1, At, B1); PG8_BAR;
            PG8_LDA(At, 1, 1); PG8_STAGE(PG8_SA(1, 0), a3, voffA);
            PG8_BAR; PG8_WAIT_L(0); PG8_MMA(1, 0, At, B0); PG8_BAR; PG8_SCHED;
            PG8_STAGE(PG8_SB(1, 1), b3 + hstep, voffB);
            PG8_WAIT_V(6); PG8_BAR; PG8_MMA(1, 1, At, B1); PG8_BAR;
            }
        }
        if constexpr (ALIGN_EPI) { if (wr == 0) PG8_BAR; }
        if constexpr (!Epi::AFTER_DRAIN) { E(acc, cur, wr, wc, fr, fq); S.done(cur); }
        if (!has_next) break;
#pragma unroll
        for (int a = 0; a < 2; ++a)
#pragma unroll
            for (int b = 0; b < 2; ++b)
#pragma unroll
                for (int m = 0; m < 4; ++m)
#pragma unroll
                    for (int n = 0; n < 2; ++n) acc[a][b][m][n] = (f32x4){0.f, 0.f, 0.f, 0.f};
        cur = nxt; cA = nA; cB = nB; ++ui;
        if constexpr (ALIGN_EPI) { if (wr == 1) PG8_BAR; }
    }
    PG8_WAIT_V(0);
    if constexpr (!ALIGN_EPI) { if (wr == 0) PG8_BAR; }
    PG8_BAR;
    if constexpr (Epi::AFTER_DRAIN) { E.fused(acc, cur, wr, wc, fr, fq, lds, wid, lane); S.done(cur); }
#undef PG8_SA
#undef PG8_SB
#undef PG8_STAGE
#undef PG8_LDA
#undef PG8_LDB
#undef PG8_MMA
#undef PG8_WAIT_V
#undef PG8_WAIT_L
#undef PG8_BAR
#undef PG8_SCHED
}
}

#ifndef PG8_SP2
#define PG8_SP2 true
#endif
#ifndef PG8_ALIGN
#define PG8_ALIGN true
#endif
constexpr int NWAVES = 8;
constexpr int DM = 1024, MP = 16384, MS = 2048, MT = MP + MS;
constexpr int NCHUNK = MT / 64;
constexpr int DFF = 2816, EVEN_IN = 1280, ODD_IN = 2048, ZE_LD = 1280, ZO_LD = 1536;
constexpr int N_PHASES = 11;
#ifndef MK_N_LAUNCHES
#define MK_N_LAUNCHES 1
#endif
enum { I_XP = 0, I_XS, I_SPOOL, I_SK, I_SV, I_SCONV, I_NMIX, I_NFFN, I_WINE, I_QN, I_KN, I_SINK, I_POOLW, I_POOLS, I_WOUTE, I_WINO, I_CONVW, I_CONVB, I_CLNG, I_CLNB,
       I_GLNG, I_GLNB, I_GW, I_GB, I_WOUTO, I_FG, I_FU, I_FD, N_IN };
constexpr size_t O_Y = 0, O_POOLP = (size_t)MT * DM, O_POOLS = O_POOLP + 15 * 512, O_KP = O_POOLS + 32 * 15 * 512, O_KS = O_KP + 128 * 128, O_VP = O_KS + 32 * 128 * 128,
                 O_VS = O_VP + 128 * 128, O_CONVP = O_VS + 32 * 128 * 128, O_CONVS = O_CONVP + 30 * 512, O_GV = O_CONVS + 32 * 30 * 512, O_END = O_GV + 32 * 64 * 512;
constexpr size_t MiB = 1u << 20;
constexpr size_t WS_CTL = 0, CTL_ZERO_BYTES = 1 * MiB;
constexpr size_t WS_WINE = 1 * MiB, WS_WOUTE = 4 * MiB, WS_WINO = 6 * MiB, WS_WOUTO = 10 * MiB, WS_WGU0 = 12 * MiB, WS_WGU1 = 23 * MiB, WS_WD0 = 34 * MiB, WS_WD1 = 40 * MiB, WS_WGM = 46 * MiB;
constexpr size_t WS_SSQ = 47 * MiB;
constexpr size_t WS_XB = 50 * MiB;
constexpr size_t WS_Z = 86 * MiB;
constexpr size_t WS_AB = 140 * MiB;
constexpr size_t WS_H = 86 * MiB;
constexpr size_t WS_END = 186 * MiB;
static_assert(WS_WINE + (size_t)EVEN_IN * DM * 2 <= WS_WOUTE && WS_WINO + (size_t)ODD_IN * DM * 2 <= WS_WOUTO && WS_WGU0 + (size_t)2 * DFF * DM * 2 <= WS_WGU1 && WS_WGU1 + (size_t)2 * DFF * DM * 2 <= WS_WD0 &&
              WS_WD0 + (size_t)DM * DFF * 2 <= WS_WD1 && WS_WD1 + (size_t)DM * DFF * 2 <= WS_WGM && WS_WGM + 4 * 128 * 128 * 2 <= WS_SSQ && WS_SSQ + (size_t)MT * 16 * 4 <= WS_XB &&
              WS_XB + (size_t)MT * DM * 2 <= WS_Z && WS_Z + (size_t)MT * ZO_LD * 2 <= WS_AB && WS_AB + (size_t)MT * DM * 2 <= WS_END && WS_H + (size_t)MT * DFF * 2 <= WS_END, "d_ws map");
constexpr int CW_BAR = 4096;
constexpr int RING_OFF = 0, RING_BYTES = 131072;
constexpr int LDSCTL_OFF = RING_BYTES, MISC_OFF = LDSCTL_OFF + 320;
constexpr int LDS_BYTES = 147456;
static_assert(MISC_OFF + 128 <= LDS_BYTES, "LDS map");

#define GAS __attribute__((address_space(1)))
#define LAS __attribute__((address_space(3)))
typedef unsigned short bf16;
typedef unsigned v4u __attribute__((ext_vector_type(4)));
typedef unsigned v2u __attribute__((ext_vector_type(2)));
typedef float f32x4 __attribute__((ext_vector_type(4)));
typedef float f32x16 __attribute__((ext_vector_type(16)));
typedef short bf16x8 __attribute__((ext_vector_type(8)));
typedef short s16x4 __attribute__((ext_vector_type(4)));
typedef GAS unsigned gu32;
#define RLX_AGENT __ATOMIC_RELAXED, __HIP_MEMORY_SCOPE_AGENT
#define LDS_WAIT() asm volatile("s_waitcnt lgkmcnt(0)" ::: "memory")
#define VM_WAIT() asm volatile("s_waitcnt vmcnt(0)" ::: "memory")
using pg8::cvt_pk_bf16; using pg8::pack8;
__device__ __forceinline__ float bflo(unsigned u) { return __uint_as_float(u << 16); }
__device__ __forceinline__ float bfhi(unsigned u) { return __uint_as_float(u & 0xffff0000u); }
__device__ __forceinline__ void unpack8(v4u w, float (&f)[8]) { f[0] = bflo(w.x); f[1] = bfhi(w.x); f[2] = bflo(w.y); f[3] = bfhi(w.y); f[4] = bflo(w.z); f[5] = bfhi(w.z); f[6] = bflo(w.w); f[7] = bfhi(w.w); }
__device__ __forceinline__ v4u pack8f(const float (&f)[8]) { v4u w; w.x = cvt_pk_bf16(f[0], f[1]); w.y = cvt_pk_bf16(f[2], f[3]); w.z = cvt_pk_bf16(f[4], f[5]); w.w = cvt_pk_bf16(f[6], f[7]); return w; }
__device__ __forceinline__ float wave_sum(float v) {
#pragma unroll
    for (int o = 1; o < 64; o <<= 1) v += __shfl_xor(v, o);
    return v;
}

#define XB_TMO      128
#define XB_XCNT(j)  (256  + 64 * (j))
#define XB_XSUB(j)  (1280 + 64 * (j))
#define XB_XGEN(j)  (2304 + 64 * (j))
#define XB_TOP      3328
#define XB_TOPGEN   3392
#define XCD_BAR_WORDS 3456
#define XB_SPIN_CAP (1u << 18)
__device__ __forceinline__ unsigned xb_ld(unsigned* p)              { return __hip_atomic_load(p, __ATOMIC_RELAXED, __HIP_MEMORY_SCOPE_AGENT); }
__device__ __forceinline__ unsigned xb_add(unsigned* p, unsigned v) { return __hip_atomic_fetch_add(p, v, __ATOMIC_RELAXED, __HIP_MEMORY_SCOPE_AGENT); }
__device__ __forceinline__ unsigned xb_xcc_id() { return (unsigned)__builtin_amdgcn_s_getreg((3 << 11) | 20) & 0xFu; }
#define XB_SPIN(cond, bar) do { unsigned _sp = 0; while (cond) { __builtin_amdgcn_s_sleep(1); \
    if ((++_sp & 255u) == 0u) { if (xb_ld(&(bar)[XB_TMO])) break; if (_sp > XB_SPIN_CAP) { atomicAdd(&(bar)[XB_TMO], 1u); break; } } } } while (0)
struct XcdBarrier { unsigned* bar; unsigned x; volatile LAS unsigned* st; };
__device__ __forceinline__ XcdBarrier xcd_barrier_post(unsigned* bar, volatile LAS unsigned* st) {
    XcdBarrier b; b.bar = bar; b.x = xb_xcc_id(); b.st = st;
    if (threadIdx.x == 0) (void)xb_add(&bar[XB_XCNT(b.x)], 1u);
    return b;
}
__device__ __forceinline__ void xcd_barrier_complete(unsigned* bar, unsigned x, unsigned& nloc, unsigned& nx) {
    const unsigned G = gridDim.x * gridDim.y * gridDim.z;
    unsigned sum, cnt, mine, sp = 0u;
    for (;;) {
        sum = 0u; cnt = 0u; mine = 0u;
#pragma unroll
        for (unsigned j = 0; j < 16; ++j) { const unsigned c = xb_ld(&bar[XB_XCNT(j)]); sum += c; cnt += (c > 0u) ? 1u : 0u; mine = (j == x) ? c : mine; }
        if (sum == G) break;
        __builtin_amdgcn_s_sleep(1);
        if ((++sp & 255u) == 0u) { if (xb_ld(&bar[XB_TMO])) break; if (sp > XB_SPIN_CAP) { atomicAdd(&bar[XB_TMO], 1u); break; } }
    }
    nloc = mine > 0u ? mine : 1u; nx = cnt > 0u ? cnt : 1u;
}
__device__ __forceinline__ void xcd_barrier(const XcdBarrier& b) {
    asm volatile("s_waitcnt vmcnt(0)" ::: "memory");
    __syncthreads();
    if (threadIdx.x == 0) {
        unsigned* bar = b.bar;
        __builtin_amdgcn_s_waitcnt(0);
        unsigned nloc = b.st[0], nx = b.st[1];
        if (nloc == 0u) { xcd_barrier_complete(bar, b.x, nloc, nx); b.st[0] = nloc; b.st[1] = nx; }
        const unsigned old = xb_add(&bar[XB_XSUB(b.x)], 1u);
        const unsigned gen = old / nloc;
        if (old + 1u == (gen + 1u) * nloc) {
            __builtin_amdgcn_fence(__ATOMIC_RELEASE, "agent");
            asm volatile("s_waitcnt vmcnt(0)" ::: "memory");
            const unsigned og = xb_add(&bar[XB_TOP], 1u);
            const unsigned tg = og / nx;
            if (og + 1u == (tg + 1u) * nx) xb_add(&bar[XB_TOPGEN], 1u);
            else XB_SPIN(xb_ld(&bar[XB_TOPGEN]) == tg, bar);
            __builtin_amdgcn_fence(__ATOMIC_ACQUIRE, "agent");
            xb_add(&bar[XB_XGEN(b.x)], 1u);
            asm volatile("s_waitcnt vmcnt(0)" ::: "memory");
        } else {
            XB_SPIN(xb_ld(&bar[XB_XGEN(b.x)]) == gen, bar);
            __builtin_amdgcn_fence(__ATOMIC_ACQUIRE, "agent");
            asm volatile("s_waitcnt vmcnt(0)" ::: "memory");
        }
    }
    __syncthreads();
}

struct Frame {
    LAS unsigned char* lds;
    int tid, lane, wave;
    int vcu, G;
    const float* in[N_IN];
    float* out; unsigned char* ws;
};
__device__ __forceinline__ void transpose_item(const float* W, int ldw, int k0, int n0, const float* gk, bf16* dst, int ldd, int drow0, LAS float* scr, int lane) {
#pragma unroll 8
    for (int i = 0; i < 32; ++i) { const int kk = 2 * i + (lane >> 5); float v = W[(size_t)(k0 + kk) * ldw + n0 + (lane & 31)]; if (gk) v *= gk[k0 + kk]; scr[kk * 33 + (lane & 31)] = v; }
    LDS_WAIT(); asm volatile("" ::: "memory");
    const int c = lane & 7;
#pragma unroll
    for (int j = 0; j < 4; ++j) { const int n = (lane >> 3) + 8 * j; const LAS float* s = scr + (8 * c) * 33 + n;
        v4u o; o.x = cvt_pk_bf16(s[0 * 33], s[1 * 33]); o.y = cvt_pk_bf16(s[2 * 33], s[3 * 33]); o.z = cvt_pk_bf16(s[4 * 33], s[5 * 33]); o.w = cvt_pk_bf16(s[6 * 33], s[7 * 33]);
        *(GAS v4u*)(dst + (size_t)(drow0 + n) * ldd + k0 + 8 * c) = o; }
    LDS_WAIT(); asm volatile("" ::: "memory");
}
__device__ __forceinline__ void p0_prologue(const Frame& F) {
    LAS float* scr = (LAS float*)(F.lds + RING_OFF + F.wave * 16384);
    const int gw = F.vcu * NWAVES + F.wave, NGW = F.G * NWAVES, lane = F.lane;
    unsigned char* ws = F.ws;
    constexpr int S0 = 16 * 40, S1 = S0 + 8 * 32, S2 = S1 + 16 * 64, S3 = S2 + 16 * 32, SF = 16 * 88, SD = 44 * 32;
    constexpr int S4 = S3 + SF, S5 = S4 + SF, S6 = S5 + SD, S7 = S6 + SF, S8 = S7 + SF, S9 = S8 + SD;
    for (int it = gw; it < S9; it += NGW) {
        if (it < S0) {
            const int kb = it / 40, nb = it % 40, c = 32 * nb, pn = c >> 8, loc = c & 255, w = loc >> 6, b = (loc >> 5) & 1;
            transpose_item(F.in[I_WINE], EVEN_IN, 64 * kb, c, F.in[I_NMIX], (bf16*)(ws + WS_WINE), DM, 256 * pn + 128 * b + 32 * w, scr, lane);
        } else if (it < S1) {
            const int r = it - S0, kb = r / 32, nb = r % 32;
            transpose_item(F.in[I_WOUTE], DM, 512 + 64 * kb, 32 * nb, nullptr, (bf16*)(ws + WS_WOUTE), DM, 32 * nb, scr, lane);
        } else if (it < S2) {
            const int r = it - S1, kb = r / 64, nb = r % 64, c = 32 * nb;
            int drow;
            if (c < 512) drow = 256 * (c >> 7) + 32 * ((c >> 5) & 3);
            else if (c < 1024) { const int c2 = c - 512; drow = 256 * (c2 >> 7) + 128 + 32 * ((c2 >> 5) & 3); }
            else drow = c;
            transpose_item(F.in[I_WINO], ODD_IN, 64 * kb, c, F.in[I_NMIX] + DM, (bf16*)(ws + WS_WINO), DM, drow, scr, lane);
        } else if (it < S3) {
            const int r = it - S2, kb = r / 32, nb = r % 32;
            transpose_item(F.in[I_WOUTO], DM, 64 * kb, 32 * nb, nullptr, (bf16*)(ws + WS_WOUTO), DM, 32 * nb, scr, lane);
        } else {
            int r = it - S3; const int layer = r >= (2 * SF + SD) ? 1 : 0; r -= layer * (2 * SF + SD);
            if (r < 2 * SF) {
                const int isup = r >= SF ? 1 : 0; r -= isup * SF;
                const int kb = r / 88, nb = r % 88, c = 32 * nb;
                transpose_item(F.in[isup ? I_FU : I_FG] + (size_t)layer * DM * DFF, DFF, 64 * kb, c, F.in[I_NFFN] + layer * DM,
                               (bf16*)(ws + (layer ? WS_WGU1 : WS_WGU0)), DM, 256 * (c >> 7) + 128 * isup + 32 * ((c >> 5) & 3), scr, lane);
            } else {
                r -= 2 * SF; const int kb = r / 32, nb = r % 32;
                transpose_item(F.in[I_FD] + (size_t)layer * DFF * DM, DM, 64 * kb, 32 * nb, nullptr, (bf16*)(ws + (layer ? WS_WD1 : WS_WD0)), DFF, 32 * nb, scr, lane);
            }
        }
    }
    {
        const float* pw = F.in[I_POOLW]; const float* ps = F.in[I_POOLS]; const float* wo = F.in[I_WOUTE]; bf16* dst = (bf16*)(ws + WS_WOUTE);
        for (int it = gw; it < 2048; it += NGW) {
            const int r = it >> 2, eq = it & 3, g = r >> 7, e = 256 * eq + 4 * lane;
            f32x4 a = {0.f, 0.f, 0.f, 0.f};
            const float* pwr = pw + (size_t)r * 128; const float* psr = ps + 128 * g; const float* wor = wo + (size_t)(128 * g) * DM + e;
#pragma unroll 4
            for (int d = 0; d < 128; ++d) { const float cf = pwr[d] * psr[d]; a += cf * *(const f32x4*)(wor + (size_t)d * DM); }
#pragma unroll
            for (int j = 0; j < 4; ++j) dst[(size_t)(e + j) * DM + r] = (bf16)(cvt_pk_bf16(a[j], 0.f) & 0xffffu);
        }
    }
    {
        const float* gwt = F.in[I_GW]; bf16* dst = (bf16*)(ws + WS_WGM);
        for (int i = (gw * 64 + lane); i < 4 * 128 * 128; i += NGW * 64) { const int ii = (i >> 7) & 127, jj = i & 127; dst[i] = (bf16)(cvt_pk_bf16(jj <= ii ? gwt[i] : 0.f, 0.f) & 0xffffu); }
    }
    {
        bf16* xb = (bf16*)(ws + WS_XB); float* ssq = (float*)(ws + WS_SSQ);
        for (int m = gw; m < MT; m += NGW) {
            const float* xr = (m < MP ? F.in[I_XP] + (size_t)m * DM : F.in[I_XS] + (size_t)(m - MP) * DM);
            const GAS f32x4* xv = (const GAS f32x4*)xr + lane;
            f32x4 v[4]; float s = 0.f;
#pragma unroll
            for (int j = 0; j < 4; ++j) { v[j] = xv[64 * j]; s += pg8::sum4sq(v[j]); }
            s = wave_sum(s);
            GAS v2u* o8 = (GAS v2u*)(xb + (size_t)m * DM) + lane;
#pragma unroll
            for (int j = 0; j < 4; ++j) { v2u w; w.x = cvt_pk_bf16(v[j][0], v[j][1]); w.y = cvt_pk_bf16(v[j][2], v[j][3]); o8[64 * j] = w; }
            if (lane < 16) ssq[(size_t)m * 16 + lane] = lane == 0 ? s : 0.f;
        }
    }
}

__device__ __forceinline__ int crow(int r, int hi) { return (r & 3) + 8 * (r >> 2) + 4 * hi; }
constexpr int KT_PITCH = 144, VT_PITCH = 392, KT_OFF = 0, VT_OFF = 192 * KT_PITCH;
static_assert(VT_OFF % 16 == 0 && VT_OFF + 64 * VT_PITCH <= RING_BYTES, "attention LDS");
__device__ __forceinline__ void even_mixer_phase(const Frame& F) {
    const int tid = F.tid, lane = F.lane, wave = F.wave, r32 = lane & 31, hi = lane >> 5;
    LAS unsigned char* lds = F.lds + RING_OFF;
    const bf16* Z = (const bf16*)(F.ws + WS_Z); bf16* AB = (bf16*)(F.ws + WS_AB);
    const float* spool = F.in[I_SPOOL]; const float* sk = F.in[I_SK]; const float* sv = F.in[I_SV];
    float* out = F.out;
    for (int it = F.vcu; it < NCHUNK * 2; it += F.G) {
        const int cidx = it >> 1, kvh = it & 1, R0 = 64 * cidx;
        const bool samp = cidx >= 256; const int st = cidx - 256;
#pragma unroll 1
        for (int i = 0; i < 3; ++i) {
            const int q = tid + 512 * i, s = q >> 3, ch = q & 7;
            v4u kw = {0u, 0u, 0u, 0u}, vw = {0u, 0u, 0u, 0u};
            float kf[8], vf[8]; bool have = false, from_state = false;
            if (!samp) {
                const int grow = R0 - 128 + s;
                if (grow >= 0) { const bf16* zr = Z + (size_t)grow * ZE_LD; kw = *(const v4u*)(zr + 1024 + 64 * kvh + 8 * ch); vw = *(const v4u*)(zr + 1152 + 64 * kvh + 8 * ch); have = true; }
            } else if (s >= 128) {
                const bf16* zr = Z + (size_t)(R0 + s - 128) * ZE_LD; kw = *(const v4u*)(zr + 1024 + 64 * kvh + 8 * ch); vw = *(const v4u*)(zr + 1152 + 64 * kvh + 8 * ch); have = true;
            } else {
                const size_t so = ((size_t)(st * 128 + s) * 2 + kvh) * 64 + 8 * ch;
                const f32x4 k0 = *(const f32x4*)(sk + so), k1 = *(const f32x4*)(sk + so + 4), v0 = *(const f32x4*)(sv + so), v1 = *(const f32x4*)(sv + so + 4);
                kf[0] = k0[0]; kf[1] = k0[1]; kf[2] = k0[2]; kf[3] = k0[3]; kf[4] = k1[0]; kf[5] = k1[1]; kf[6] = k1[2]; kf[7] = k1[3];
                vf[0] = v0[0]; vf[1] = v0[1]; vf[2] = v0[2]; vf[3] = v0[3]; vf[4] = v1[0]; vf[5] = v1[1]; vf[6] = v1[2]; vf[7] = v1[3];
                kw = pack8f(kf); vw = pack8f(vf); have = true; from_state = true;
            }
            *(LAS v4u*)(lds + KT_OFF + s * KT_PITCH + ch * 16) = kw;
            {
                LAS bf16* vt = (LAS bf16*)(lds + VT_OFF) + s;
                const unsigned e[4] = {vw.x, vw.y, vw.z, vw.w};
#pragma unroll
                for (int j = 0; j < 4; ++j) { vt[(8 * ch + 2 * j) * (VT_PITCH / 2)] = (bf16)(e[j] & 0xffffu); vt[(8 * ch + 2 * j + 1) * (VT_PITCH / 2)] = (bf16)(e[j] >> 16); }
            }
            if (have) {
                int orow = -1; float* ko = nullptr; float* vo = nullptr;
                if (samp) { if (s >= 64) { orow = s - 64; ko = out + O_KS + (size_t)st * 128 * 128; vo = out + O_VS + (size_t)st * 128 * 128; } }
                else if (cidx >= 254 && s >= 128) { orow = 64 * (cidx - 254) + (s - 128); ko = out + O_KP; vo = out + O_VP; }
                if (orow >= 0) {
                    if (!from_state) { unpack8(kw, kf); unpack8(vw, vf); }
                    const size_t oo = ((size_t)orow * 2 + kvh) * 64 + 8 * ch;
                    *(f32x4*)(ko + oo) = (f32x4){kf[0], kf[1], kf[2], kf[3]}; *(f32x4*)(ko + oo + 4) = (f32x4){kf[4], kf[5], kf[6], kf[7]};
                    *(f32x4*)(vo + oo) = (f32x4){vf[0], vf[1], vf[2], vf[3]}; *(f32x4*)(vo + oo + 4) = (f32x4){vf[4], vf[5], vf[6], vf[7]};
                }
            }
        }
#pragma unroll 1
        for (int i = 0; i < 4; ++i) {
            const int t = tid + 512 * i, rl = t >> 5, cc = t & 31, col = 256 * kvh + 8 * cc, grp = col >> 7, w = 2 << grp, row = R0 + rl;
            float a[8] = {0.f, 0.f, 0.f, 0.f, 0.f, 0.f, 0.f, 0.f}, f[8];
            int cnt = w;
            if (!samp) { if (row + 1 < w) cnt = row + 1; }
            for (int j = 1; j < w; ++j) {
                const int idx = rl - j;
                if (samp && idx < 0) {
                    const float* sp = spool + ((size_t)st * 15 + 15 + idx) * 512 + col;
                    const f32x4 p0 = *(const f32x4*)sp, p1 = *(const f32x4*)(sp + 4);
                    a[0] += p0[0]; a[1] += p0[1]; a[2] += p0[2]; a[3] += p0[3]; a[4] += p1[0]; a[5] += p1[1]; a[6] += p1[2]; a[7] += p1[3];
                } else if (row - j >= 0) {
                    unpack8(*(const v4u*)(Z + (size_t)(row - j) * ZE_LD + col), f);
#pragma unroll
                    for (int e = 0; e < 8; ++e) a[e] += f[e];
                }
            }
            unpack8(*(const v4u*)(Z + (size_t)row * ZE_LD + col), f);
            const float inv = 1.0f / (float)cnt;
            float o[8];
#pragma unroll
            for (int e = 0; e < 8; ++e) o[e] = (a[e] + f[e]) * inv - f[e];
            *(v4u*)(AB + (size_t)row * DM + col) = pack8f(o);
            if (rl >= 49 && (samp || cidx == 255)) {
                float* po = samp ? out + O_POOLS + ((size_t)st * 15 + (rl - 49)) * 512 + col : out + O_POOLP + (size_t)(rl - 49) * 512 + col;
                *(f32x4*)po = (f32x4){f[0], f[1], f[2], f[3]}; *(f32x4*)(po + 4) = (f32x4){f[4], f[5], f[6], f[7]};
            }
        }
        const int g = wave >> 1, rh = wave & 1, hq = 4 * kvh + g;
        bf16x8 qf[4];
        {
            const bf16* qp = Z + (size_t)(R0 + 32 * rh + r32) * ZE_LD + 512 + 64 * hq + 8 * hi;
#pragma unroll
            for (int d0 = 0; d0 < 4; ++d0) qf[d0] = *(const bf16x8*)(qp + 16 * d0);
        }
        LDS_WAIT(); __syncthreads();
        f32x16 sc[6];
#pragma unroll
        for (int kt = 0; kt < 6; ++kt) {
            sc[kt] = (f32x16){0.f, 0.f, 0.f, 0.f, 0.f, 0.f, 0.f, 0.f, 0.f, 0.f, 0.f, 0.f, 0.f, 0.f, 0.f, 0.f};
#pragma unroll
            for (int d0 = 0; d0 < 4; ++d0) {
                const bf16x8 kfr = *(const LAS bf16x8*)(lds + KT_OFF + (32 * kt + r32) * KT_PITCH + (2 * d0 + hi) * 16);
                sc[kt] = __builtin_amdgcn_mfma_f32_32x32x16_bf16(kfr, qf[d0], sc[kt], 0, 0, 0);
            }
        }
        constexpr float L2E = 1.4426950408889634f;
        const float sink = F.in[I_SINK][hq] * L2E;
        float slope = __builtin_amdgcn_exp2f(-(float)(hq + 1)) * L2E, scl = 0.125f * L2E;
        const int smin = samp ? 0 : (cidx >= 2 ? 0 : 128 - 64 * cidx);
        float qoff = (float)(128 + 32 * rh + r32 - 4 * hi);
        asm volatile("" : "+v"(qoff), "+v"(slope), "+v"(scl));
        float mx = -INFINITY;
#pragma unroll
        for (int kt = 0; kt < 6; ++kt)
#pragma unroll
            for (int r = 0; r < 16; ++r) {
                const int sb = 32 * kt + (r & 3) + 8 * (r >> 2);
                float v = sc[kt][r] * scl - slope * __builtin_fabsf(qoff - (float)sb);
                if (sb + 4 * hi < smin) v = -INFINITY;
                sc[kt][r] = v; mx = __builtin_fmaxf(mx, v);
            }
        mx = __builtin_fmaxf(mx, __shfl_xor(mx, 32));
        mx = __builtin_fmaxf(mx, sink);
        float sum = 0.f;
#pragma unroll
        for (int kt = 0; kt < 6; ++kt)
#pragma unroll
            for (int r = 0; r < 16; ++r) { const float p = __builtin_amdgcn_exp2f(sc[kt][r] - mx); sc[kt][r] = p; sum += p; }
        sum += __shfl_xor(sum, 32);
        const float inv = 1.0f / (sum + __builtin_amdgcn_exp2f(sink - mx));
        f32x16 o[2];
        o[0] = (f32x16){0.f, 0.f, 0.f, 0.f, 0.f, 0.f, 0.f, 0.f, 0.f, 0.f, 0.f, 0.f, 0.f, 0.f, 0.f, 0.f}; o[1] = o[0];
#pragma unroll
        for (int kt = 0; kt < 6; ++kt)
#pragma unroll
            for (int sub = 0; sub < 2; ++sub) {
                v4u pw;
                pw.x = cvt_pk_bf16(sc[kt][8 * sub + 0] * inv, sc[kt][8 * sub + 1] * inv); pw.y = cvt_pk_bf16(sc[kt][8 * sub + 2] * inv, sc[kt][8 * sub + 3] * inv);
                pw.z = cvt_pk_bf16(sc[kt][8 * sub + 4] * inv, sc[kt][8 * sub + 5] * inv); pw.w = cvt_pk_bf16(sc[kt][8 * sub + 6] * inv, sc[kt][8 * sub + 7] * inv);
                const bf16x8 pf = __builtin_bit_cast(bf16x8, pw);
#pragma unroll
                for (int dt = 0; dt < 2; ++dt) {
                    const LAS unsigned char* vp = lds + VT_OFF + (32 * dt + r32) * VT_PITCH + (32 * kt + 16 * sub + 4 * hi) * 2;
                    const s16x4 lo = *(const LAS s16x4*)vp, hh = *(const LAS s16x4*)(vp + 16);
                    const bf16x8 vfr = (bf16x8){lo[0], lo[1], lo[2], lo[3], hh[0], hh[1], hh[2], hh[3]};
                    o[dt] = __builtin_amdgcn_mfma_f32_32x32x16_bf16(pf, vfr, o[dt], 0, 0, 0);
                }
            }
        {
            bf16* op = AB + (size_t)(R0 + 32 * rh) * DM + 512 + 64 * hq + r32;
#pragma unroll
            for (int dt = 0; dt < 2; ++dt)
#pragma unroll
                for (int r = 0; r < 16; ++r) op[(size_t)crow(r, hi) * DM + 32 * dt] = (bf16)(cvt_pk_bf16(o[dt][r], 0.f) & 0xffffu);
        }
        LDS_WAIT(); __syncthreads();
    }
}
constexpr int CW_LDS_OFF = 0, CW_LDS_BYTES = 31 * 512 * 4, VN_OFF = CW_LDS_BYTES, VN_PITCH = 272;
static_assert(VN_OFF % 16 == 0 && VN_OFF + 128 * VN_PITCH <= RING_BYTES, "odd mixer LDS");
constexpr int N_CONV_ITEMS = NCHUNK, N_GMLP_ITEMS = (MP / 128 + 32) * 4;
__device__ __forceinline__ void odd_mixer_phase(const Frame& F) {
    const int tid = F.tid, lane = F.lane, wave = F.wave, r32 = lane & 31, hi = lane >> 5;
    LAS unsigned char* lds = F.lds + RING_OFF;
    const bf16* Z = (const bf16*)(F.ws + WS_Z); bf16* AB = (bf16*)(F.ws + WS_AB);
    float* out = F.out;
    {
        const float* cw = F.in[I_CONVW];
        for (int i = tid; i < 31 * 512 / 4; i += 512) *(LAS f32x4*)(lds + CW_LDS_OFF + i * 16) = *(const f32x4*)(cw + 4 * i);
    }
    LDS_WAIT(); __syncthreads();
    for (int it = F.vcu; it < N_CONV_ITEMS + N_GMLP_ITEMS; it += F.G) {
        if (it < N_CONV_ITEMS) {
            const int cidx = it, R0 = 64 * cidx; const bool samp = cidx >= 256; const int st = cidx - 256;
            const int ch = 8 * lane, t0 = 8 * wave;
            float acc[8][8];
#pragma unroll
            for (int a = 0; a < 8; ++a)
#pragma unroll
                for (int e = 0; e < 8; ++e) acc[a][e] = 0.f;
#pragma unroll 1
            for (int e0 = 0; e0 < 38; ++e0) {
                const int idx = t0 - 30 + e0;
                float x[8];
                bool nz = true;
                if (samp && idx < 0) {
                    const float* sp = F.in[I_SCONV] + ((size_t)st * 30 + 30 + idx) * 512 + ch;
                    const f32x4 p0 = *(const f32x4*)sp, p1 = *(const f32x4*)(sp + 4);
                    x[0] = p0[0]; x[1] = p0[1]; x[2] = p0[2]; x[3] = p0[3]; x[4] = p1[0]; x[5] = p1[1]; x[6] = p1[2]; x[7] = p1[3];
                } else if (R0 + idx >= 0) {
                    unpack8(*(const v4u*)(Z + (size_t)(R0 + idx) * ZO_LD + ch), x);
                } else nz = false;
                if (nz) {
#pragma unroll
                    for (int tt = 0; tt < 8; ++tt) {
                        const int j = e0 - tt;
                        if (j >= 0 && j <= 30) {
                            const f32x4 w0 = *(const LAS f32x4*)(lds + CW_LDS_OFF + (j * 512 + ch) * 4), w1 = *(const LAS f32x4*)(lds + CW_LDS_OFF + (j * 512 + ch) * 4 + 16);
                            acc[tt][0] += w0[0] * x[0]; acc[tt][1] += w0[1] * x[1]; acc[tt][2] += w0[2] * x[2]; acc[tt][3] += w0[3] * x[3];
                            acc[tt][4] += w1[0] * x[4]; acc[tt][5] += w1[1] * x[5]; acc[tt][6] += w1[2] * x[6]; acc[tt][7] += w1[3] * x[7];
                        }
                    }
                }
            }
            float cb[8], lg[8], lb[8];
            {
                const f32x4 b0 = *(const f32x4*)(F.in[I_CONVB] + ch), b1 = *(const f32x4*)(F.in[I_CONVB] + ch + 4), g0 = *(const f32x4*)(F.in[I_CLNG] + ch), g1 = *(const f32x4*)(F.in[I_CLNG] + ch + 4),
                            l0 = *(const f32x4*)(F.in[I_CLNB] + ch), l1 = *(const f32x4*)(F.in[I_CLNB] + ch + 4);
#pragma unroll
                for (int e = 0; e < 4; ++e) { cb[e] = b0[e]; cb[e + 4] = b1[e]; lg[e] = g0[e]; lg[e + 4] = g1[e]; lb[e] = l0[e]; lb[e + 4] = l1[e]; }
            }
#pragma unroll
            for (int tt = 0; tt < 8; ++tt) {
                float s = 0.f;
#pragma unroll
                for (int e = 0; e < 8; ++e) { acc[tt][e] += cb[e]; s += acc[tt][e]; }
                const float mean = wave_sum(s) * (1.0f / 512.0f);
                float q = 0.f;
#pragma unroll
                for (int e = 0; e < 8; ++e) { const float d = acc[tt][e] - mean; q += d * d; }
                const float rstd = __builtin_amdgcn_rsqf(wave_sum(q) * (1.0f / 512.0f) + 1e-5f);
                float o[8];
#pragma unroll
                for (int e = 0; e < 8; ++e) { const float y = (acc[tt][e] - mean) * rstd * lg[e] + lb[e]; o[e] = y * pg8::sigmoidf_fast(y); }
                *(v4u*)(AB + (size_t)(R0 + t0 + tt) * DM + ch) = pack8f(o);
            }
            if (samp || cidx == 255) {
                for (int t = tid; t < 30 * 64; t += 512) {
                    const int rr = t >> 6, c8 = 8 * (t & 63); float f[8];
                    unpack8(*(const v4u*)(Z + (size_t)(R0 + 34 + rr) * ZO_LD + c8), f);
                    float* po = samp ? out + O_CONVS + ((size_t)st * 30 + rr) * 512 + c8 : out + O_CONVP + (size_t)rr * 512 + c8;
                    *(f32x4*)po = (f32x4){f[0], f[1], f[2], f[3]}; *(f32x4*)(po + 4) = (f32x4){f[4], f[5], f[6], f[7]};
                }
            }
        } else {
            const int gi = it - N_CONV_ITEMS, chunk = gi >> 2, g = gi & 3;
            const bool samp = chunk >= MP / 128; const int st = chunk - MP / 128;
            const int rowbase = samp ? MP + 64 * st : 128 * chunk, nrows = samp ? 64 : 128;
            {
                const int ch = 8 * lane;
                float lg[8], lb[8];
                {
                    const f32x4 g0 = *(const f32x4*)(F.in[I_GLNG] + ch), g1 = *(const f32x4*)(F.in[I_GLNG] + ch + 4), l0 = *(const f32x4*)(F.in[I_GLNB] + ch), l1 = *(const f32x4*)(F.in[I_GLNB] + ch + 4);
#pragma unroll
                    for (int e = 0; e < 4; ++e) { lg[e] = g0[e]; lg[e + 4] = g1[e]; lb[e] = l0[e]; lb[e + 4] = l1[e]; }
                }
#pragma unroll 2
                for (int jj = 0; jj < 16; ++jj) {
                    const int j = 16 * wave + jj;
                    if (j < nrows) {
                        float x[8]; unpack8(*(const v4u*)(Z + (size_t)(rowbase + j) * ZO_LD + 1024 + ch), x);
                        float s = 0.f;
#pragma unroll
                        for (int e = 0; e < 8; ++e) s += x[e];
                        const float mean = wave_sum(s) * (1.0f / 512.0f);
                        float q = 0.f;
#pragma unroll
                        for (int e = 0; e < 8; ++e) { const float d = x[e] - mean; q += d * d; }
                        const float rstd = __builtin_amdgcn_rsqf(wave_sum(q) * (1.0f / 512.0f) + 1e-5f);
                        float vn[8];
#pragma unroll
                        for (int e = 0; e < 8; ++e) vn[e] = (x[e] - mean) * rstd * lg[e] + lb[e];
                        if (samp && g == 0) {
                            float* po = out + O_GV + ((size_t)st * 64 + j) * 512 + ch;
                            *(f32x4*)po = (f32x4){vn[0], vn[1], vn[2], vn[3]}; *(f32x4*)(po + 4) = (f32x4){vn[4], vn[5], vn[6], vn[7]};
                        }
                        if ((lane >> 4) == g) {
                            LAS bf16* vt = (LAS bf16*)(lds + VN_OFF) + j;
                            const int c0 = 8 * (lane & 15);
#pragma unroll
                            for (int e = 0; e < 8; e += 2) { const unsigned w = cvt_pk_bf16(vn[e], vn[e + 1]); vt[(c0 + e) * (VN_PITCH / 2)] = (bf16)(w & 0xffffu); vt[(c0 + e + 1) * (VN_PITCH / 2)] = (bf16)(w >> 16); }
                        }
                    }
                }
            }
            LDS_WAIT(); __syncthreads();
            {
                const int ib = wave >> 1, chh = wave & 1;
                if (32 * ib < nrows) {
                    const bf16* Wm = (const bf16*)(F.ws + WS_WGM) + (size_t)g * 128 * 128 + (size_t)(32 * ib + r32) * 128 + 8 * hi;
                    f32x16 s[2];
                    s[0] = (f32x16){0.f, 0.f, 0.f, 0.f, 0.f, 0.f, 0.f, 0.f, 0.f, 0.f, 0.f, 0.f, 0.f, 0.f, 0.f, 0.f}; s[1] = s[0];
                    const int nks = 2 * (ib + 1);
#pragma unroll 2
                    for (int ks = 0; ks < nks; ++ks) {
                        const bf16x8 af = *(const bf16x8*)(Wm + 16 * ks);
#pragma unroll
                        for (int t = 0; t < 2; ++t) {
                            const bf16x8 bfr = *(const LAS bf16x8*)(lds + VN_OFF + (64 * chh + 32 * t + r32) * VN_PITCH + (16 * ks + 8 * hi) * 2);
                            s[t] = __builtin_amdgcn_mfma_f32_32x32x16_bf16(af, bfr, s[t], 0, 0, 0);
                        }
                    }
                    const float* bsp = F.in[I_GB] + 128 * g;
#pragma unroll
                    for (int t = 0; t < 2; ++t)
#pragma unroll
                        for (int r = 0; r < 16; ++r) {
                            const int i = 32 * ib + crow(r, hi), c = 128 * g + 64 * chh + 32 * t + r32;
                            const size_t row = (size_t)(rowbase + i);
                            const float zu = bflo((unsigned)Z[row * ZO_LD + 512 + c]);
                            AB[row * DM + 512 + c] = (bf16)(cvt_pk_bf16((s[t][r] + bsp[i]) * zu, 0.f) & 0xffffu);
                        }
                }
            }
            LDS_WAIT(); __syncthreads();
        }
    }
}
struct Args { const float* in[N_IN]; float* out; unsigned char* ws; int ph_lo, ph_hi; };
static_assert(sizeof(Args) == N_IN * 8 + 8 + 8 + 8, "Args has no padding bytes");
__global__ void __launch_bounds__(NWAVES * 64, 2) skel_fwd(Args args) {
    __shared__ __attribute__((aligned(16))) unsigned char lds_raw[LDS_BYTES];
    Frame F;
    F.lds = (LAS unsigned char*)lds_raw;
    F.tid = threadIdx.x; F.lane = F.tid & 63; F.wave = __builtin_amdgcn_readfirstlane(F.tid >> 6);
    F.G = gridDim.x; { const int bx = blockIdx.x; F.vcu = (F.G % 8 == 0) ? (bx % 8) * (F.G / 8) + bx / 8 : bx; }
#pragma unroll
    for (int i = 0; i < N_IN; ++i) F.in[i] = args.in[i];
    F.out = args.out; F.ws = args.ws;
    volatile LAS unsigned* MISC = (volatile LAS unsigned*)(F.lds + MISC_OFF);
    gu32* ctl = (gu32*)(F.ws + WS_CTL);
    for (int u = F.tid; u < (LDS_BYTES - LDSCTL_OFF) / 4; u += NWAVES * 64) ((LAS unsigned*)(F.lds + LDSCTL_OFF))[u] = 0u;
    __syncthreads();
    const int lo = args.ph_lo, hi = args.ph_hi;
    const bool multi = (hi - lo) > 1;
    XcdBarrier bar; bar.bar = (unsigned*)(ctl + CW_BAR); bar.x = 0; bar.st = nullptr;
    if (multi) bar = xcd_barrier_post((unsigned*)(ctl + CW_BAR), MISC + 8);
#ifdef ONLY_PHASE
#define IN(k) ((k) == ONLY_PHASE && lo <= (k) && (k) < hi)
#else
#define IN(k) (lo <= (k) && (k) < hi)
#endif
#define SEAM(k) do { if (IN(k) && IN((k) + 1)) xcd_barrier(bar); } while (0)
    unsigned char* ws = F.ws;
    float* ssq = (float*)(ws + WS_SSQ); bf16* XB = (bf16*)(ws + WS_XB); bf16* Zb = (bf16*)(ws + WS_Z); bf16* AB = (bf16*)(ws + WS_AB); bf16* HB = (bf16*)(ws + WS_H);
    const int bid = (int)blockIdx.x;

    if (IN(0)) { p0_prologue(F); } SEAM(0);
    if (IN(1)) {
        pg8::Gemm g{XB, (const bf16*)(ws + WS_WINE), MT, EVEN_IN, DM}; pg8::StaticOrder S; S.init(MT, EVEN_IN, F.G, bid);
        pg8::EpiEvenIn E{Zb, ssq, F.in[I_QN], F.in[I_KN]};
        pg8::gemm_phase<pg8::EpiEvenIn, pg8::StaticOrder, PG8_ALIGN, PG8_SP2>(F.lds + RING_OFF, g, S, E);
    } SEAM(1);
    if (IN(2)) { even_mixer_phase(F); } SEAM(2);
    if (IN(3)) {
        pg8::Gemm g{AB, (const bf16*)(ws + WS_WOUTE), MT, DM, DM}; pg8::StaticOrder S; S.init(MT, DM, F.G, bid);
        pg8::EpiResid E{F.in[I_XP], F.in[I_XS], F.out + O_Y, XB, ssq, MP};
        pg8::gemm_phase<pg8::EpiResid, pg8::StaticOrder, PG8_ALIGN, PG8_SP2>(F.lds + RING_OFF, g, S, E);
    } SEAM(3);
    if (IN(4)) {
        pg8::Gemm g{XB, (const bf16*)(ws + WS_WGU0), MT, 2 * DFF, DM}; pg8::StaticOrder S; S.init(MT, 2 * DFF, F.G, bid);
        pg8::EpiSwiGLU E{HB, ssq, DFF};
        pg8::gemm_phase<pg8::EpiSwiGLU, pg8::StaticOrder, PG8_ALIGN, PG8_SP2>(F.lds + RING_OFF, g, S, E);
    } SEAM(4);
    if (IN(5)) {
        pg8::Gemm g{HB, (const bf16*)(ws + WS_WD0), MT, DM, DFF}; pg8::StaticOrder S; S.init(MT, DM, F.G, bid);
        pg8::EpiResid E{F.out + O_Y, F.out + O_Y + (size_t)MP * DM, F.out + O_Y, XB, ssq, MP};
        pg8::gemm_phase<pg8::EpiResid, pg8::StaticOrder, PG8_ALIGN, PG8_SP2>(F.lds + RING_OFF, g, S, E);
    } SEAM(5);
    if (IN(6)) {
        pg8::Gemm g{XB, (const bf16*)(ws + WS_WINO), MT, ODD_IN, DM}; pg8::StaticOrder S; S.init(MT, ODD_IN, F.G, bid);
        pg8::EpiOddIn E{Zb, ssq};
        pg8::gemm_phase<pg8::EpiOddIn, pg8::StaticOrder, PG8_ALIGN, PG8_SP2>(F.lds + RING_OFF, g, S, E);
    } SEAM(6);
    if (IN(7)) { odd_mixer_phase(F); } SEAM(7);
    if (IN(8)) {
        pg8::Gemm g{AB, (const bf16*)(ws + WS_WOUTO), MT, DM, DM}; pg8::StaticOrder S; S.init(MT, DM, F.G, bid);
        pg8::EpiResid E{F.out + O_Y, F.out + O_Y + (size_t)MP * DM, F.out + O_Y, XB, ssq, MP};
        pg8::gemm_phase<pg8::EpiResid, pg8::StaticOrder, PG8_ALIGN, PG8_SP2>(F.lds + RING_OFF, g, S, E);
    } SEAM(8);
    if (IN(9)) {
        pg8::Gemm g{XB, (const bf16*)(ws + WS_WGU1), MT, 2 * DFF, DM}; pg8::StaticOrder S; S.init(MT, 2 * DFF, F.G, bid);
        pg8::EpiSwiGLU E{HB, ssq, DFF};
        pg8::gemm_phase<pg8::EpiSwiGLU, pg8::StaticOrder, PG8_ALIGN, PG8_SP2>(F.lds + RING_OFF, g, S, E);
    } SEAM(9);
    if (IN(10)) {
        pg8::Gemm g{HB, (const bf16*)(ws + WS_WD1), MT, DM, DFF}; pg8::StaticOrder S; S.init(MT, DM, F.G, bid);
        pg8::EpiResid E{F.out + O_Y, F.out + O_Y + (size_t)MP * DM, F.out + O_Y, XB, ssq, MP};
        pg8::gemm_phase<pg8::EpiResid, pg8::StaticOrder, PG8_ALIGN, PG8_SP2>(F.lds + RING_OFF, g, S, E);
    }
#undef IN
#undef SEAM
}

extern "C" void kernel_launch(void* const* d_in, const int* in_sizes, int n_in, void* d_out, int out_size, void* d_ws, size_t ws_size, hipStream_t stream) {
    static int grid = 0;
    if (grid == 0) {
        if (n_in != N_IN || out_size != (int)O_END || ws_size < WS_END) { fprintf(stderr, "kernel_launch: unexpected sizes: n_in %d out %d ws %zu\n", n_in, out_size, ws_size); grid = -1; return; }
        int dev = 0, cus = 0;
        if (hipGetDevice(&dev) != hipSuccess || hipDeviceGetAttribute(&cus, hipDeviceAttributeMultiprocessorCount, dev) != hipSuccess) { grid = -1; return; }
        grid = cus;
    }
    if (grid < 0) return;
    (void)hipMemsetAsync((char*)d_ws + WS_CTL, 0, CTL_ZERO_BYTES, stream);
    Args a{};
    for (int i = 0; i < N_IN; ++i) a.in[i] = (const float*)d_in[i];
    a.out = (float*)d_out; a.ws = (unsigned char*)d_ws;
    constexpr int NL = MK_N_LAUNCHES;
    for (int li = 0; li < NL; ++li) {
        a.ph_lo = (NL == 1) ? 0 : li; a.ph_hi = (NL == 1) ? N_PHASES : li + 1;
        hipLaunchKernelGGL(skel_fwd, dim3(grid), dim3(NWAVES * 64), 0, stream, a);
    }
}
```
